# Optimizing an MI355X kernel written in HIP

```python
import math
import jax, jax.numpy as jnp
from jax import lax
import numpy as np

D_MODEL = 1024
BATCH = 16
SEQ = 2048
DEPTH = 2

N_EVEN = (DEPTH + 1) // 2
N_ODD = DEPTH // 2
EPS = 1e-6

CONF_WIDTH = D_MODEL // 2
CONF_KERNEL = 31
LRU_WIDTH = D_MODEL // 2
LRU_HEADS = 8
LRU_HEAD_DIM = LRU_WIDTH // LRU_HEADS
LRU_CONV = 4
LRU_C = 8.0
AB_IN = 2 * CONF_WIDTH + 2 * LRU_WIDTH
AB_OUT = CONF_WIDTH + LRU_WIDTH
ML_HEADS = 8
ML_V_DIM = D_MODEL
ML_HEAD_V = ML_V_DIM // ML_HEADS
ML_HEAD_QK = ML_HEAD_V // 2
ML_QK_DIM = ML_HEADS * ML_HEAD_QK
ML_CHUNK = 64
ML_IN = 2 * ML_QK_DIM + 2 * ML_V_DIM + 2 * ML_HEADS
D_FF = int(math.ceil(8 * D_MODEL / 3 / 256)) * 256

kernel_name = 'hybrid_conformer_rglru_mlstm_block'


def _rmsnorm(x, g):
    xf = x.astype(jnp.float32)
    y = xf * lax.rsqrt(jnp.mean(xf * xf, axis=-1, keepdims=True) + EPS)
    return (y * g.astype(jnp.float32)).astype(x.dtype)


def _layernorm(x, g, b):
    xf = x.astype(jnp.float32)
    mu = jnp.mean(xf, axis=-1, keepdims=True)
    var = jnp.mean(jnp.square(xf - mu), axis=-1, keepdims=True)
    y = (xf - mu) * lax.rsqrt(var + EPS)
    return (y * g.astype(jnp.float32) + b.astype(jnp.float32)).astype(x.dtype)


def _causal_dwconv(x, w, b):
    k = w.shape[0]
    c = x.shape[-1]
    y = lax.conv_general_dilated(
        x, w[:, None, :].astype(x.dtype), window_strides=(1,), padding=[(k - 1, 0)],
        dimension_numbers=('NWC', 'WIO', 'NWC'), feature_group_count=c)
    return y + b


def _conformer_conv(u, conv_w, conv_b, ln_g, ln_b):
    val, gate = jnp.split(u, 2, axis=-1)
    y = val * jax.nn.sigmoid(gate)
    y = _causal_dwconv(y, conv_w, conv_b)
    return jax.nn.silu(_layernorm(y, ln_g, ln_b))


def _lru_combine(left, right):
    a_l, b_l = left
    a_r, b_r = right
    return a_l * a_r, a_r * b_l + b_r


def _rglru_block(u, conv_w, conv_b, w_a, b_a, w_x, b_x, lam):
    bsz, seq, _ = u.shape
    gate_in, rec_in = jnp.split(u, 2, axis=-1)
    xr = _causal_dwconv(rec_in, conv_w, conv_b)
    xh = xr.reshape(bsz, seq, LRU_HEADS, LRU_HEAD_DIM)
    r = jax.nn.sigmoid(jnp.einsum('bshd,hde->bshe', xh, w_a) + b_a)
    i = jax.nn.sigmoid(jnp.einsum('bshd,hde->bshe', xh, w_x) + b_x)
    log_base = -jax.nn.softplus(-lam.astype(jnp.float32)).reshape(LRU_HEADS, LRU_HEAD_DIM)
    log_a = LRU_C * log_base * r.astype(jnp.float32)
    a = jnp.exp(log_a)
    gated_x = jnp.sqrt(-jnp.expm1(2.0 * log_a)) * (i * xh).astype(jnp.float32)
    _, h = lax.associative_scan(_lru_combine, (a, gated_x), axis=1)
    h = h.reshape(bsz, seq, LRU_WIDTH).astype(u.dtype)
    return h * jax.nn.gelu(gate_in)


def _ab_mixer(xn, w_in, b_in, conf_conv_w, conf_conv_b, conf_ln_g, conf_ln_b,
              lru_conv_w, lru_conv_b, lru_w_a, lru_b_a, lru_w_x, lru_b_x, lru_lambda, w_out):
    u = jnp.einsum('bsd,de->bse', xn, w_in) + b_in
    u_conf, u_lru = jnp.split(u, [2 * CONF_WIDTH], axis=-1)
    y_a = _conformer_conv(u_conf, conf_conv_w, conf_conv_b, conf_ln_g, conf_ln_b)
    y_b = _rglru_block(u_lru, lru_conv_w, lru_conv_b, lru_w_a, lru_b_a, lru_w_x, lru_b_x, lru_lambda)
    y = jnp.concatenate([y_a, y_b], axis=-1)
    return jnp.einsum('bse,ed->bsd', y, w_out)


def _mlstm_chunk_step(carry, inp):
    c_state, n_state, m_state = carry
    qc, kc, vc, ic, lfc = inp
    L = qc.shape[2]
    causal = jnp.tril(jnp.ones((L, L), dtype=bool))
    b = jnp.cumsum(lfc, axis=-1)
    log_d = b[..., :, None] - b[..., None, :] + ic[..., None, :]
    log_d = jnp.where(causal, log_d, -jnp.inf)
    log_inter = b + m_state[..., None]
    m_row = jnp.maximum(log_inter, jnp.max(log_d, axis=-1))
    d_w = jnp.exp(log_d - m_row[..., None])
    inter_w = jnp.exp(log_inter - m_row)
    scores = jnp.einsum('bhjd,bhsd->bhjs', qc, kc) * d_w
    num = jnp.einsum('bhjs,bhsv->bhjv', scores, vc) + inter_w[..., None] * jnp.einsum('bhjd,bhdv->bhjv', qc, c_state)
    den = jnp.sum(scores, axis=-1) + inter_w * jnp.einsum('bhjd,bhd->bhj', qc, n_state)
    h = num / jnp.maximum(jnp.abs(den), jnp.exp(-m_row))[..., None]
    b_last = b[..., -1]
    log_w = b_last[..., None] - b + ic
    m_new = jnp.maximum(b_last + m_state, jnp.max(log_w, axis=-1))
    w_s = jnp.exp(log_w - m_new[..., None])
    decay = jnp.exp(b_last + m_state - m_new)
    c_new = decay[..., None, None] * c_state + jnp.einsum('bhsd,bhsv->bhdv', w_s[..., None] * kc, vc)
    n_new = decay[..., None] * n_state + jnp.einsum('bhs,bhsd->bhd', w_s, kc)
    return (c_new, n_new, m_new), h


def _mlstm_mixer(xn, w_in, b_in, head_g, w_out):
    bsz, seq, _ = xn.shape
    nc = seq // ML_CHUNK
    u = jnp.einsum('bsd,de->bse', xn, w_in) + b_in
    q, k, v, o, ig, fg = jnp.split(
        u, [ML_QK_DIM, 2 * ML_QK_DIM, 2 * ML_QK_DIM + ML_V_DIM,
            2 * ML_QK_DIM + 2 * ML_V_DIM, 2 * ML_QK_DIM + 2 * ML_V_DIM + ML_HEADS], axis=-1)
    f32 = jnp.float32

    def to_chunks(t, d):
        return t.astype(f32).reshape(bsz, nc, ML_CHUNK, ML_HEADS, d).transpose(1, 0, 3, 2, 4)

    def gate_chunks(t):
        return t.astype(f32).reshape(bsz, nc, ML_CHUNK, ML_HEADS).transpose(1, 0, 3, 2)

    qc = to_chunks(q, ML_HEAD_QK)
    kc = to_chunks(k, ML_HEAD_QK) * (ML_HEAD_QK ** -0.5)
    vc = to_chunks(v, ML_HEAD_V)
    ic = gate_chunks(ig)
    lfc = gate_chunks(jax.nn.log_sigmoid(fg))
    init = (jnp.zeros((bsz, ML_HEADS, ML_HEAD_QK, ML_HEAD_V), f32),
            jnp.zeros((bsz, ML_HEADS, ML_HEAD_QK), f32),
            jnp.zeros((bsz, ML_HEADS), f32))
    _, h = lax.scan(_mlstm_chunk_step, init, (qc, kc, vc, ic, lfc))
    h = h.transpose(1, 0, 3, 2, 4).reshape(bsz, seq, ML_HEADS, ML_HEAD_V)
    h = h * lax.rsqrt(jnp.mean(h * h, axis=-1, keepdims=True) + EPS)
    h = (h.reshape(bsz, seq, ML_V_DIM) * head_g.astype(f32)).astype(xn.dtype)
    h = jax.nn.sigmoid(o) * h
    return jnp.einsum('bse,ed->bsd', h, w_out)


def _swiglu(xn, w_gate, w_up, w_down):
    g = jnp.einsum('bsd,df->bsf', xn, w_gate)
    up = jnp.einsum('bsd,df->bsf', xn, w_up)
    return jnp.einsum('bsf,fd->bsd', jax.nn.silu(g) * up, w_down)


def setup_inputs(seed: int = 0) -> dict:
    key = jax.random.key(seed)
    ks = iter(jax.random.split(key, 40))

    def nrm(shape, scale):
        return jax.random.normal(next(ks), shape, jnp.float32) * scale

    def gain(shape):
        return 1.0 + nrm(shape, 0.05)

    lam_u = jax.random.uniform(next(ks), (N_EVEN, LRU_WIDTH), jnp.float32, minval=0.9, maxval=0.999)
    lam_base = lam_u ** (1.0 / LRU_C)
    lru_lambda = jnp.log(lam_base) - jnp.log1p(-lam_base)

    ml_b_in = nrm((N_ODD, ML_IN), 0.02)
    f_bias = jnp.linspace(3.0, 6.0, ML_HEADS, dtype=jnp.float32) + nrm((N_ODD, ML_HEADS), 0.1)
    ml_b_in = ml_b_in.at[:, ML_IN - ML_HEADS:].set(f_bias)

    return {
        'x': nrm((BATCH, SEQ, D_MODEL), 1.0),
        'pre_mix_g': gain((DEPTH, D_MODEL)),
        'post_mix_g': gain((DEPTH, D_MODEL)),
        'pre_ffn_g': gain((DEPTH, D_MODEL)),
        'post_ffn_g': gain((DEPTH, D_MODEL)),
        'ab_w_in': nrm((N_EVEN, D_MODEL, AB_IN), D_MODEL ** -0.5),
        'ab_b_in': nrm((N_EVEN, AB_IN), 0.02),
        'conf_conv_w': nrm((N_EVEN, CONF_KERNEL, CONF_WIDTH), CONF_KERNEL ** -0.5),
        'conf_conv_b': nrm((N_EVEN, CONF_WIDTH), 0.02),
        'conf_ln_g': gain((N_EVEN, CONF_WIDTH)),
        'conf_ln_b': nrm((N_EVEN, CONF_WIDTH), 0.02),
        'lru_conv_w': nrm((N_EVEN, LRU_CONV, LRU_WIDTH), LRU_CONV ** -0.5),
        'lru_conv_b': nrm((N_EVEN, LRU_WIDTH), 0.02),
        'lru_w_a': nrm((N_EVEN, LRU_HEADS, LRU_HEAD_DIM, LRU_HEAD_DIM), LRU_HEAD_DIM ** -0.5),
        'lru_b_a': nrm((N_EVEN, LRU_HEADS, LRU_HEAD_DIM), 0.02),
        'lru_w_x': nrm((N_EVEN, LRU_HEADS, LRU_HEAD_DIM, LRU_HEAD_DIM), LRU_HEAD_DIM ** -0.5),
        'lru_b_x': nrm((N_EVEN, LRU_HEADS, LRU_HEAD_DIM), 0.02),
        'lru_lambda': lru_lambda,
        'ab_w_out': nrm((N_EVEN, AB_OUT, D_MODEL), AB_OUT ** -0.5),
        'ml_w_in': nrm((N_ODD, D_MODEL, ML_IN), D_MODEL ** -0.5),
        'ml_b_in': ml_b_in,
        'ml_head_g': gain((N_ODD, ML_V_DIM)),
        'ml_w_out': nrm((N_ODD, ML_V_DIM, D_MODEL), ML_V_DIM ** -0.5),
        'ffn_w_gate': nrm((DEPTH, D_MODEL, D_FF), D_MODEL ** -0.5),
        'ffn_w_up': nrm((DEPTH, D_MODEL, D_FF), D_MODEL ** -0.5),
        'ffn_w_down': nrm((DEPTH, D_FF, D_MODEL), D_FF ** -0.5),
    }


def reference(x, pre_mix_g, post_mix_g, pre_ffn_g, post_ffn_g,
              ab_w_in, ab_b_in, conf_conv_w, conf_conv_b, conf_ln_g, conf_ln_b,
              lru_conv_w, lru_conv_b, lru_w_a, lru_b_a, lru_w_x, lru_b_x, lru_lambda, ab_w_out,
              ml_w_in, ml_b_in, ml_head_g, ml_w_out,
              ffn_w_gate, ffn_w_up, ffn_w_down):
    for layer in range(DEPTH):
        j = layer // 2
        h = _rmsnorm(x, pre_mix_g[layer])
        if layer % 2 == 0:
            h = _ab_mixer(h, ab_w_in[j], ab_b_in[j], conf_conv_w[j], conf_conv_b[j],
                          conf_ln_g[j], conf_ln_b[j], lru_conv_w[j], lru_conv_b[j],
                          lru_w_a[j], lru_b_a[j], lru_w_x[j], lru_b_x[j], lru_lambda[j], ab_w_out[j])
        else:
            h = _mlstm_mixer(h, ml_w_in[j], ml_b_in[j], ml_head_g[j], ml_w_out[j])
        x = x + _rmsnorm(h, post_mix_g[layer])
        h = _swiglu(_rmsnorm(x, pre_ffn_g[layer]), ffn_w_gate[layer], ffn_w_up[layer], ffn_w_down[layer])
        x = x + _rmsnorm(h, post_ffn_g[layer])
    return x
```

```cpp
#include <hip/hip_runtime.h>
#include <cstdio>
#include <cstdint>
namespace pg8 {
#define PG8_LAS __attribute__((address_space(3)))
typedef unsigned short bf16_t;
typedef short bf16x8 __attribute__((ext_vector_type(8)));
typedef float f32x4 __attribute__((ext_vector_type(4)));
typedef unsigned u32x4 __attribute__((ext_vector_type(4)));
constexpr int BM = 256, BK = 64, HALF = 128, HTB = HALF * BK * 2  , STAGE_BYTES = 8 * HTB, NXCD = 8, WGM = 8;

__host__ __device__ __forceinline__ int lds_byte(int r, int c) { const int st = (r >> 4) * 2 + (c >> 5), rr = r & 15, cc = c & 31, ob = rr * 64 + cc * 2; return st * 1024 + (ob ^ (((ob >> 9) & 1) << 5)); }
__host__ __device__ __forceinline__ void stage_rc(int b, int& R, int& C) { const int st = b / 1024, sb = b % 1024, swz = sb ^ (((sb >> 9) & 1) << 5); R = (st >> 1) * 16 + swz / 64; C = (st & 1) * 32 + (swz % 64) / 2; }
__host__ __device__ __forceinline__ int perm32(int rho) { const int n = rho >> 4, i = rho & 15; return 8 * (i >> 2) + 4 * n + (i & 3); }

struct Unit { int pm, pn; };
struct Gemm { const bf16_t* A; const bf16_t* Bt; int M, N, K; };

struct StaticOrder {
    int nM, nN, nwg, G, c;
    __host__ __device__ void init(int M, int N, int G_, int c_) { nM = M / BM; nN = N / BM; nwg = nM * nN; G = G_; c = c_; }
    __host__ __device__ bool next(int i, Unit& u) const {
        const long L = (long)i * G + c; if (L >= nwg) return false;
        int wgid = (int)L; { const int q = nwg / NXCD, r = nwg % NXCD, xcd = wgid % NXCD, off = wgid / NXCD; wgid = (xcd < r ? xcd * (q + 1) : r * (q + 1) + (xcd - r) * q) + off; }
        const int nig = WGM * nN, gid = wgid / nig, fm = gid * WGM, gsz = (nM - fm) < WGM ? (nM - fm) : WGM;
        u.pm = fm + ((wgid % nig) % gsz); u.pn = (wgid % nig) / gsz; return true;
    }
    __device__ __forceinline__ void a_ready(const Unit&) const {}
    __device__ __forceinline__ void done(const Unit&) const {}
};
__device__ __forceinline__ unsigned cvt_pk_bf16(float lo, float hi) { unsigned r; asm volatile("v_cvt_pk_bf16_f32 %0, %1, %2" : "=v"(r) : "v"(lo), "v"(hi)); return r; }
typedef float f32x2 __attribute__((ext_vector_type(2)));
__device__ __forceinline__ float sigm(float x) { return __builtin_amdgcn_rcpf(1.0f + __expf(-x)); }
__device__ __forceinline__ float gelu_tanh(float x) { return x * sigm(1.5957691216f * (x + 0.044715f * x * x * x)); }
__device__ __forceinline__ float logsigm(float x) { return fminf(x, 0.f) - log1pf(__expf(-fabsf(x))); }
__device__ __forceinline__ u32x4 pack8(const f32x4 a, const f32x4 b) { u32x4 w; w.x = cvt_pk_bf16(a[0], a[1]); w.y = cvt_pk_bf16(a[2], a[3]); w.z = cvt_pk_bf16(b[0], b[1]); w.w = cvt_pk_bf16(b[2], b[3]); return w; }

struct EpiPlain {
    static constexpr bool PERM = true, AFTER_DRAIN = false;
    bf16_t* O; int ldc;
    __device__ __forceinline__ void operator()(const f32x4 (&acc)[2][2][4][2], const Unit& u, int wr, int wc, int fr, int fq) const {
        const int row0 = u.pm * BM + wr * 64 + fr, col0 = u.pn * BM + wc * 32 + 8 * fq;
#pragma unroll
        for (int ai = 0; ai < 2; ++ai)
#pragma unroll
            for (int m = 0; m < 4; ++m) { bf16_t* rowp = O + (size_t)(row0 + ai * HALF + m * 16) * ldc + col0;
#pragma unroll
                for (int bj = 0; bj < 2; ++bj) *(u32x4*)(rowp + bj * HALF) = pack8(acc[ai][bj][m][0], acc[ai][bj][m][1]); }
    }
};
struct EpiAB {
    static constexpr bool PERM = true, AFTER_DRAIN = false;
    bf16_t* yglu; bf16_t* ggelu; bf16_t* rec; const float* rs; const float* bias;
    __device__ __forceinline__ void operator()(const f32x4 (&acc)[2][2][4][2], const Unit& u, int wr, int wc, int fr, int fq) const {
        const int row0 = u.pm * BM + wr * 64 + fr, cl = wc * 32 + 8 * fq, bcol0 = u.pn * BM + cl;
        f32x4 bv[2][2];
#pragma unroll
        for (int bj = 0; bj < 2; ++bj)
#pragma unroll
            for (int n = 0; n < 2; ++n) bv[bj][n] = *(const f32x4*)(bias + bcol0 + bj * HALF + 4 * n);
        const bool conf = u.pn < 4; const int ch0 = (u.pn & 3) * HALF + cl;
#pragma unroll
        for (int ai = 0; ai < 2; ++ai)
#pragma unroll
            for (int m = 0; m < 4; ++m) { const int row = row0 + ai * HALF + m * 16; const float s = rs[row];
                f32x4 a0 = acc[ai][0][m][0] * s + bv[0][0], a1 = acc[ai][0][m][1] * s + bv[0][1], b0 = acc[ai][1][m][0] * s + bv[1][0], b1 = acc[ai][1][m][1] * s + bv[1][1];
                const size_t off = (size_t)row * 512 + ch0;
                if (conf) {
#pragma unroll
                    for (int j = 0; j < 4; ++j) { a0[j] = a0[j] * sigm(b0[j]); a1[j] = a1[j] * sigm(b1[j]); }
                    *(u32x4*)(yglu + off) = pack8(a0, a1);
                } else {
#pragma unroll
                    for (int j = 0; j < 4; ++j) { a0[j] = gelu_tanh(a0[j]); a1[j] = gelu_tanh(a1[j]); }
                    *(u32x4*)(ggelu + off) = pack8(a0, a1); *(u32x4*)(rec + off) = pack8(b0, b1);
                } }
    }
};
struct EpiSwiGLU {
    static constexpr bool PERM = true, AFTER_DRAIN = false;
    bf16_t* H; const float* rs; int ldc;
    __device__ __forceinline__ void operator()(const f32x4 (&acc)[2][2][4][2], const Unit& u, int wr, int wc, int fr, int fq) const {
        const int row0 = u.pm * BM + wr * 64 + fr, col0 = u.pn * HALF + wc * 32 + 8 * fq;
#pragma unroll
        for (int ai = 0; ai < 2; ++ai)
#pragma unroll
            for (int m = 0; m < 4; ++m) { const int row = row0 + ai * HALF + m * 16; const float s = rs[row];
                f32x4 g0 = acc[ai][0][m][0] * s, g1 = acc[ai][0][m][1] * s, u0 = acc[ai][1][m][0] * s, u1 = acc[ai][1][m][1] * s;
#pragma unroll
                for (int j = 0; j < 4; ++j) { g0[j] = g0[j] * sigm(g0[j]) * u0[j]; g1[j] = g1[j] * sigm(g1[j]) * u1[j]; }
                *(u32x4*)(H + (size_t)row * ldc + col0) = pack8(g0, g1); }
    }
};
struct EpiML {
    static constexpr bool PERM = true, AFTER_DRAIN = false;
    bf16_t* Q; bf16_t* Kk; bf16_t* V; bf16_t* So; float* Gt; const float* rs; const float* bias;
    __device__ __forceinline__ void operator()(const f32x4 (&acc)[2][2][4][2], const Unit& u, int wr, int wc, int fr, int fq) const {
        const int row0 = u.pm * BM + wr * 64 + fr, cl = wc * 32 + 8 * fq, bcol0 = u.pn * BM + cl;
        f32x4 bv[2][2];
#pragma unroll
        for (int bj = 0; bj < 2; ++bj)
#pragma unroll
            for (int n = 0; n < 2; ++n) bv[bj][n] = *(const f32x4*)(bias + bcol0 + bj * HALF + 4 * n);
        const int pn = u.pn;
        if (pn == 12) {
            if (cl < 16) {
#pragma unroll
                for (int ai = 0; ai < 2; ++ai)
#pragma unroll
                    for (int m = 0; m < 4; ++m) { const int row = row0 + ai * HALF + m * 16; const float s = rs[row];
                        f32x4 a0 = acc[ai][0][m][0] * s + bv[0][0], a1 = acc[ai][0][m][1] * s + bv[0][1];
                        if (cl >= 8) {
#pragma unroll
                            for (int j = 0; j < 4; ++j) { a0[j] = logsigm(a0[j]); a1[j] = logsigm(a1[j]); } }
                        *(f32x4*)(Gt + (size_t)row * 16 + cl) = a0; *(f32x4*)(Gt + (size_t)row * 16 + cl + 4) = a1; }
            }
            return;
        }
        bf16_t* base; int ldc, colt;
        if (pn < 2) { base = Q; ldc = 512; colt = pn * BM; } else if (pn < 4) { base = Kk; ldc = 512; colt = (pn - 2) * BM; }
        else if (pn < 8) { base = V; ldc = 1024; colt = (pn - 4) * BM; } else { base = So; ldc = 1024; colt = (pn - 8) * BM; }
        const bool sg = pn >= 8;
#pragma unroll
        for (int ai = 0; ai < 2; ++ai)
#pragma unroll
            for (int m = 0; m < 4; ++m) { const int row = row0 + ai * HALF + m * 16; const float s = rs[row];
#pragma unroll
                for (int bj = 0; bj < 2; ++bj) { f32x4 a0 = acc[ai][bj][m][0] * s + bv[bj][0], a1 = acc[ai][bj][m][1] * s + bv[bj][1];
                    if (sg) {
#pragma unroll
                        for (int j = 0; j < 4; ++j) { a0[j] = sigm(a0[j]); a1[j] = sigm(a1[j]); } }
                    *(u32x4*)(base + (size_t)row * ldc + colt + bj * HALF + cl) = pack8(a0, a1); } }
    }
};
template <class Epi, class Sched, bool ALIGN_EPI = false, bool SP2 = false>
__device__ __forceinline__ void gemm_phase(PG8_LAS unsigned char* lds, const Gemm g, const Sched& S, const Epi& E) {
    const int tid = threadIdx.x, wid = __builtin_amdgcn_readfirstlane(tid >> 6), lane = tid & 63, wr = wid >> 2, wc = wid & 3, fr = lane & 15, fq = lane >> 4;
    const int K = g.K, nt = K / BK;
    unsigned voffA[2], voffB[2];
#pragma unroll
    for (int i = 0; i < 2; ++i) { int R, C; stage_rc(tid * 16 + i * 8192, R, C); const int Rb = Epi::PERM ? ((R & ~31) + perm32(R & 31)) : R;
        voffA[i] = (unsigned)(R * K + C) * 2u; voffB[i] = (unsigned)(Rb * K + C) * 2u; }
    const size_t kstep = (size_t)(BK * 2);
    const size_t hstep = (size_t)HALF * K * 2;
    const size_t tstep = 2 * hstep;
    const unsigned ldsw = (unsigned)wid * 1024u;
    const int aoff = lds_byte(wr * 64 + fr, fq * 8), boff = lds_byte(wc * 32 + fr, fq * 8);
#define PG8_SA(b, h) (((b) * 2 + (h)) * HTB)
#define PG8_SB(b, h) ((4 + (b) * 2 + (h)) * HTB)
#define PG8_STAGE(bufoff, gbase, voff) do { _Pragma("unroll") for (int _i = 0; _i < 2; ++_i) \
        __builtin_amdgcn_global_load_lds((const unsigned*)((const char*)(gbase) + (voff)[_i]), (PG8_LAS unsigned*)(lds + (bufoff) + ldsw + _i * 8192), 16, 0, 0); } while (0)
#define PG8_LDA(dst, b, h) do { _Pragma("unroll") for (int m = 0; m < 4; ++m) _Pragma("unroll") for (int k = 0; k < 2; ++k) dst[m][k] = *(const PG8_LAS bf16x8*)(lds + PG8_SA(b, h) + aoff + m * 2048 + k * 1024); } while (0)
#define PG8_LDB(dst, b, h) do { _Pragma("unroll") for (int n = 0; n < 2; ++n) _Pragma("unroll") for (int k = 0; k < 2; ++k) dst[n][k] = *(const PG8_LAS bf16x8*)(lds + PG8_SB(b, h) + boff + n * 2048 + k * 1024); } while (0)
#define PG8_MMA(ai, bj, At, Bt) do { __builtin_amdgcn_s_setprio(1); _Pragma("unroll") for (int m = 0; m < 4; ++m) _Pragma("unroll") for (int n = 0; n < 2; ++n) _Pragma("unroll") for (int k = 0; k < 2; ++k) \
        acc[ai][bj][m][n] = __builtin_amdgcn_mfma_f32_16x16x32_bf16(Bt[n][k], At[m][k], acc[ai][bj][m][n], 0, 0, 0); __builtin_amdgcn_s_setprio(0); } while (0)
#define PG8_WAIT_V(n) asm volatile("s_waitcnt vmcnt(" #n ")" ::: "memory")
#define PG8_WAIT_L(n) asm volatile("s_waitcnt lgkmcnt(" #n ")" ::: "memory")
#define PG8_BAR __builtin_amdgcn_s_barrier()
#define PG8_SCHED __builtin_amdgcn_sched_barrier(0)
    Unit cur, nxt; int ui = 0;
    if (!S.next(0, cur)) return;
    f32x4 acc[2][2][4][2];
#pragma unroll
    for (int a = 0; a < 2; ++a)
#pragma unroll
        for (int b = 0; b < 2; ++b)
#pragma unroll
            for (int m = 0; m < 4; ++m)
#pragma unroll
                for (int n = 0; n < 2; ++n) acc[a][b][m][n] = (f32x4){0.f, 0.f, 0.f, 0.f};
    bf16x8 At[4][2], B0[2][2], B1[2][2];
    const char* cA = (const char*)g.A + (size_t)cur.pm * tstep; const char* cB = (const char*)g.Bt + (size_t)cur.pn * tstep;
    S.a_ready(cur);
    if constexpr (SP2) {
        PG8_STAGE(PG8_SB(0, 0), cB, voffB); PG8_STAGE(PG8_SB(0, 1), cB + hstep, voffB); PG8_STAGE(PG8_SA(0, 0), cA, voffA); PG8_STAGE(PG8_SA(0, 1), cA + hstep, voffA);
        if (wr == 1) PG8_BAR;
        PG8_WAIT_V(2); PG8_BAR;
        PG8_STAGE(PG8_SB(1, 0), cB + kstep, voffB); PG8_STAGE(PG8_SA(1, 0), cA + kstep, voffA); PG8_STAGE(PG8_SB(1, 1), cB + hstep + kstep, voffB);
        PG8_WAIT_V(6); PG8_BAR;
    } else {
        PG8_STAGE(PG8_SB(0, 0), cB, voffB); PG8_STAGE(PG8_SA(0, 0), cA, voffA); PG8_STAGE(PG8_SB(0, 1), cB + hstep, voffB); PG8_STAGE(PG8_SA(0, 1), cA + hstep, voffA);
        if (wr == 1) PG8_BAR;
        PG8_WAIT_V(4); PG8_BAR;
        PG8_STAGE(PG8_SB(1, 0), cB + kstep, voffB); PG8_STAGE(PG8_SA(1, 0), cA + kstep, voffA); PG8_STAGE(PG8_SB(1, 1), cB + hstep + kstep, voffB);
        PG8_WAIT_V(6); PG8_BAR;
    }
    for (;;) {
        const bool has_next = S.next(ui + 1, nxt);
        const char* nA = has_next ? (const char*)g.A + (size_t)nxt.pm * tstep : cA; const char* nB = has_next ? (const char*)g.Bt + (size_t)nxt.pn * tstep : cB;
        for (int t = 0; t < nt; t += 2) {
            const bool last = (t == nt - 2);
            const char* a1 = cA + (size_t)(t + 1) * kstep;
            const char* a2 = last ? nA : cA + (size_t)(t + 2) * kstep; const char* b2 = last ? nB : cB + (size_t)(t + 2) * kstep;
            const char* a3 = a2 + kstep; const char* b3 = b2 + kstep;
            if (last && has_next) S.a_ready(nxt);
            if constexpr (SP2) {
            PG8_LDB(B0, 0, 0); PG8_LDB(B1, 0, 1); PG8_SCHED; PG8_LDA(At, 0, 0); PG8_STAGE(PG8_SA(1, 1), a1 + hstep, voffA);
            PG8_WAIT_V(8); PG8_WAIT_L(0); PG8_BAR; PG8_MMA(0, 0, At, B0); PG8_MMA(0, 1, At, B1); PG8_BAR; PG8_SCHED;
            PG8_LDA(At, 0, 1); PG8_STAGE(PG8_SB(0, 0), b2, voffB); PG8_STAGE(PG8_SB(0, 1), b2 + hstep, voffB); PG8_STAGE(PG8_SA(0, 0), a2, voffA);
            PG8_WAIT_V(8); PG8_WAIT_L(0); PG8_BAR; PG8_MMA(1, 0, At, B0); PG8_MMA(1, 1, At, B1); PG8_BAR; PG8_SCHED;
            PG8_LDB(B0, 1, 0); PG8_LDB(B1, 1, 1); PG8_SCHED; PG8_LDA(At, 1, 0); PG8_STAGE(PG8_SA(0, 1), a2 + hstep, voffA);
            PG8_WAIT_V(8); PG8_WAIT_L(0); PG8_BAR; PG8_MMA(0, 0, At, B0); PG8_MMA(0, 1, At, B1); PG8_BAR; PG8_SCHED;
            PG8_LDA(At, 1, 1); PG8_STAGE(PG8_SB(1, 0), b3, voffB); PG8_STAGE(PG8_SB(1, 1), b3 + hstep, voffB); PG8_STAGE(PG8_SA(1, 0), a3, voffA);
            PG8_WAIT_V(8); PG8_WAIT_L(0); PG8_BAR; PG8_MMA(1, 0, At, B0); PG8_MMA(1, 1, At, B1); PG8_BAR; PG8_SCHED;
            } else {
            PG8_LDB(B0, 0, 0); PG8_SCHED; PG8_LDA(At, 0, 0); PG8_STAGE(PG8_SA(1, 1), a1 + hstep, voffA);
            PG8_WAIT_L(8); PG8_BAR; PG8_WAIT_L(0); PG8_MMA(0, 0, At, B0); PG8_BAR; PG8_SCHED;
            PG8_LDB(B1, 0, 1); PG8_STAGE(PG8_SB(0, 0), b2, voffB);
            PG8_BAR; PG8_WAIT_L(0); PG8_MMA(0, 1, At, B1); PG8_BAR;
            PG8_LDA(At, 0, 1); PG8_STAGE(PG8_SA(0, 0), a2, voffA);
            PG8_BAR; PG8_WAIT_L(0); PG8_MMA(1, 0, At, B0); PG8_BAR; PG8_SCHED;
            PG8_STAGE(PG8_SB(0, 1), b2 + hstep, voffB);
            PG8_WAIT_V(6); PG8_BAR; PG8_MMA(1, 1, At, B1); PG8_BAR;
            PG8_LDB(B0, 1, 0); PG8_SCHED; PG8_LDA(At, 1, 0); PG8_STAGE(PG8_SA(0, 1), a2 + hstep, voffA);
            PG8_WAIT_L(8); PG8_BAR; PG8_WAIT_L(0); PG8_MMA(0, 0, At, B0); PG8_BAR; PG8_SCHED;
            PG8_LDB(B1, 1, 1); PG8_STAGE(PG8_SB(1, 0), b3, voffB);
            PG8_BAR; PG8_WAIT_L(0); PG8_MMA(0, 1, At, B1); PG8_BAR;
            PG8_LDA(At, 1, 1); PG8_STAGE(PG8_SA(1, 0), a3, voffA);
            PG8_BAR; PG8_WAIT_L(0); PG8_MMA(1, 0, At, B0); PG8_BAR; PG8_SCHED;
            PG8_STAGE(PG8_SB(1, 1), b3 + hstep, voffB);
            PG8_WAIT_V(6); PG8_BAR; PG8_MMA(1, 1, At, B1); PG8_BAR;
            }
        }
        if constexpr (ALIGN_EPI) { if (wr == 0) PG8_BAR; }
        if constexpr (!Epi::AFTER_DRAIN) { E(acc, cur, wr, wc, fr, fq); S.done(cur); }
        if (!has_next) break;
#pragma unroll
        for (int a = 0; a < 2; ++a)
#pragma unroll
            for (int b = 0; b < 2; ++b)
#pragma unroll
                for (int m = 0; m < 4; ++m)
#pragma unroll
                    for (int n = 0; n < 2; ++n) acc[a][b][m][n] = (f32x4){0.f, 0.f, 0.f, 0.f};
        cur = nxt; cA = nA; cB = nB; ++ui;
        if constexpr (ALIGN_EPI) { if (wr == 1) PG8_BAR; }
    }
    PG8_WAIT_V(0);
    if constexpr (!ALIGN_EPI) { if (wr == 0) PG8_BAR; }
    PG8_BAR;
    if constexpr (Epi::AFTER_DRAIN) { E.fused(acc, cur, wr, wc, fr, fq, lds, wid, lane); S.done(cur); }
#undef PG8_SA
#undef PG8_SB
#undef PG8_STAGE
#undef PG8_LDA
#undef PG8_LDB
#undef PG8_MMA
#undef PG8_WAIT_V
#undef PG8_WAIT_L
#undef PG8_BAR
#undef PG8_SCHED
}
}
constexpr int NWAVES = 8;
#ifndef MK_N_LAUNCHES
#define MK_N_LAUNCHES 1
#endif
constexpr int NPH = 15;
constexpr int N_LAUNCHES = MK_N_LAUNCHES;
static_assert(N_LAUNCHES == 1 || N_LAUNCHES == NPH, "MK_N_LAUNCHES is 1 or 15");

constexpr int BATCH = 16, SEQ = 2048, D = 1024, M = BATCH * SEQ, DFF = 2816;
constexpr int NAB = 2048, NGU = 2 * DFF, NML = 3328, NML_REAL = 3088;
constexpr float EPS = 1e-6f;

constexpr size_t MiB = 1u << 20;
constexpr size_t WS_CTL = 0, CTL_ZERO_BYTES = 1 * MiB;
constexpr size_t WS_RS = 1 * MiB;
constexpr size_t WS_BAB = 1 * MiB + 256 * 1024;
constexpr size_t WS_BML = 1 * MiB + 320 * 1024;
constexpr size_t WS_GT = 2 * MiB;
constexpr size_t WS_WAB = 4 * MiB, WS_WABO = 8 * MiB, WS_WGU0 = 10 * MiB, WS_WD0 = 21 * MiB, WS_WML = 27 * MiB, WS_WMLO = 34 * MiB, WS_WGU1 = 36 * MiB, WS_WD1 = 47 * MiB;
constexpr size_t WS_XB = 64 * MiB, WS_HB = 128 * MiB, WS_YY = 192 * MiB, WS_R = 256 * MiB, WS_END = 448 * MiB;
constexpr size_t WS_YGLU = WS_R, WS_GGELU = WS_R + 32 * MiB, WS_REC = WS_R + 64 * MiB;
constexpr size_t WS_HMID = WS_R;
constexpr size_t WS_Q = WS_R, WS_K = WS_R + 32 * MiB, WS_V = WS_R + 64 * MiB, WS_SO = WS_R + 128 * MiB;
static_assert(WS_WD1 + (size_t)D * DFF * 2 <= WS_XB && WS_HMID + (size_t)M * DFF * 2 <= WS_END && WS_SO + (size_t)M * D * 2 <= WS_END, "d_ws map");
constexpr int CW_TMO = 0, CW_CODE = 1, CW_BAR = 4096;

constexpr int RING_OFF = 0, RING_BYTES = 131072;
constexpr int LDSCTL_OFF = RING_BYTES, MISC_OFF = LDSCTL_OFF + 320;
constexpr int LDS_BYTES = 147456;
static_assert(MISC_OFF + 128 <= LDS_BYTES, "LDS map");
#define GAS __attribute__((address_space(1)))
#define LAS __attribute__((address_space(3)))
typedef unsigned short bf16;
typedef unsigned v4u __attribute__((ext_vector_type(4)));
typedef float f32x4 __attribute__((ext_vector_type(4)));
typedef short bf16x8 __attribute__((ext_vector_type(8)));
typedef GAS unsigned gu32;
typedef GAS unsigned long long gu64;
#define RLX_AGENT __ATOMIC_RELAXED, __HIP_MEMORY_SCOPE_AGENT
#define LDS_WAIT() asm volatile("s_waitcnt lgkmcnt(0)" ::: "memory")
#define VM_WAIT() asm volatile("s_waitcnt vmcnt(0)" ::: "memory")
__device__ __forceinline__ unsigned long long rt() { return __builtin_amdgcn_s_memrealtime(); }
__device__ __forceinline__ unsigned f2bf(float f) { unsigned u = __builtin_bit_cast(unsigned, f); return (u + 0x7fffu + ((u >> 16) & 1u)) >> 16; }
__device__ __forceinline__ unsigned pk2(float lo, float hi) { return f2bf(lo) | (f2bf(hi) << 16); }
#define XB_TMO      128
#define XB_XCNT(j)  (256  + 64 * (j))
#define XB_XSUB(j)  (1280 + 64 * (j))
#define XB_XGEN(j)  (2304 + 64 * (j))
#define XB_TOP      3328
#define XB_TOPGEN   3392
#define XCD_BAR_WORDS 3456
#define XB_SPIN_CAP (1u << 18)

__device__ __forceinline__ unsigned xb_ld(unsigned* p)              { return __hip_atomic_load(p, __ATOMIC_RELAXED, __HIP_MEMORY_SCOPE_AGENT); }
__device__ __forceinline__ unsigned xb_add(unsigned* p, unsigned v) { return __hip_atomic_fetch_add(p, v, __ATOMIC_RELAXED, __HIP_MEMORY_SCOPE_AGENT); }
__device__ __forceinline__ unsigned xb_xcc_id() { return (unsigned)__builtin_amdgcn_s_getreg((3 << 11) | 20) & 0xFu; }
#define XB_SPIN(cond, bar) do { unsigned _sp = 0; while (cond) { __builtin_amdgcn_s_sleep(1); \
    if ((++_sp & 255u) == 0u) { if (xb_ld(&(bar)[XB_TMO])) break; if (_sp > XB_SPIN_CAP) { atomicAdd(&(bar)[XB_TMO], 1u); break; } } } } while (0)

struct XcdBarrier {
    unsigned* bar; unsigned x;
    volatile LAS unsigned* st;
};

__device__ __forceinline__ XcdBarrier xcd_barrier_post(unsigned* bar, volatile LAS unsigned* st) {
    XcdBarrier b; b.bar = bar; b.x = xb_xcc_id(); b.st = st;
    if (threadIdx.x == 0) (void)xb_add(&bar[XB_XCNT(b.x)], 1u);
    return b;
}
__device__ __forceinline__ void xcd_barrier_complete(unsigned* bar, unsigned x, unsigned& nloc, unsigned& nx) {
    const unsigned G = gridDim.x * gridDim.y * gridDim.z;
    unsigned sum, cnt, mine, sp = 0u;
    for (;;) {
        sum = 0u; cnt = 0u; mine = 0u;
#pragma unroll
        for (unsigned j = 0; j < 16; ++j) { const unsigned c = xb_ld(&bar[XB_XCNT(j)]); sum += c; cnt += (c > 0u) ? 1u : 0u; mine = (j == x) ? c : mine; }
        if (sum == G) break;
        __builtin_amdgcn_s_sleep(1);
        if ((++sp & 255u) == 0u) { if (xb_ld(&bar[XB_TMO])) break; if (sp > XB_SPIN_CAP) { atomicAdd(&bar[XB_TMO], 1u); break; } }
    }
    nloc = mine > 0u ? mine : 1u; nx = cnt > 0u ? cnt : 1u;
}

__device__ __forceinline__ void xcd_barrier(const XcdBarrier& b) {
    asm volatile("s_waitcnt vmcnt(0)" ::: "memory");
    __syncthreads();
    if (threadIdx.x == 0) {
        unsigned* bar = b.bar;
        __builtin_amdgcn_s_waitcnt(0);
        unsigned nloc = b.st[0], nx = b.st[1];
        if (nloc == 0u) { xcd_barrier_complete(bar, b.x, nloc, nx); b.st[0] = nloc; b.st[1] = nx; }
        const unsigned old = xb_add(&bar[XB_XSUB(b.x)], 1u);
        const unsigned gen = old / nloc;
        if (old + 1u == (gen + 1u) * nloc) {
            __builtin_amdgcn_fence(__ATOMIC_RELEASE, "agent");
            asm volatile("s_waitcnt vmcnt(0)" ::: "memory");
            const unsigned og = xb_add(&bar[XB_TOP], 1u);
            const unsigned tg = og / nx;
            if (og + 1u == (tg + 1u) * nx) xb_add(&bar[XB_TOPGEN], 1u);
            else XB_SPIN(xb_ld(&bar[XB_TOPGEN]) == tg, bar);
            __builtin_amdgcn_fence(__ATOMIC_ACQUIRE, "agent");
            xb_add(&bar[XB_XGEN(b.x)], 1u);
            asm volatile("s_waitcnt vmcnt(0)" ::: "memory");
        } else {
            XB_SPIN(xb_ld(&bar[XB_XGEN(b.x)]) == gen, bar);
            __builtin_amdgcn_fence(__ATOMIC_ACQUIRE, "agent");
            asm volatile("s_waitcnt vmcnt(0)" ::: "memory");
        }
    }
    __syncthreads();
}
struct Args { const float* in[26]; float* out; unsigned char* ws; int ph_lo, ph_hi, li, pad; };
struct Frame {
    LAS unsigned char* lds;
    volatile LAS unsigned* MISC;
    gu32* ctl;
    int tid, lane, wave;
    int vcu, G;
};
__device__ __forceinline__ float wave_sum(float v) {
#pragma unroll
    for (int o = 1; o < 64; o <<= 1) v += __shfl_xor(v, o);
    return v;
}
__device__ __forceinline__ float bf2f(unsigned short h) { return __uint_as_float(((unsigned)h) << 16); }
__device__ __forceinline__ float bflo(unsigned w) { return __uint_as_float(w << 16); }
__device__ __forceinline__ float bfhi(unsigned w) { return __uint_as_float(w & 0xffff0000u); }
typedef unsigned v2u __attribute__((ext_vector_type(2)));
using pg8::cvt_pk_bf16;
using pg8::sigm;

__device__ __forceinline__ void tr_item(const float* W, int ldw, int col0, int ncv, int k0, bf16* WT, int K, int dstrow0, const float* g, float mul, LAS float* scr, int lane) {
    const int c = lane & 31;
#pragma unroll 8
    for (int i = 0; i < 32; ++i) { const int kk = 2 * i + (lane >> 5); float v = (c < ncv) ? W[(size_t)(k0 + kk) * ldw + col0 + c] : 0.f; if (g) v *= g[k0 + kk]; scr[kk * 33 + c] = v * mul; }
    LDS_WAIT(); asm volatile("" ::: "memory");
    const int c8 = lane & 7;
#pragma unroll
    for (int j = 0; j < 4; ++j) { const int n = (lane >> 3) + 8 * j; const LAS float* s = scr + (8 * c8) * 33 + n;
        v4u o; o.x = pk2(s[0 * 33], s[1 * 33]); o.y = pk2(s[2 * 33], s[3 * 33]); o.z = pk2(s[4 * 33], s[5 * 33]); o.w = pk2(s[6 * 33], s[7 * 33]);
        *(GAS v4u*)(WT + (size_t)(dstrow0 + n) * K + k0 + 8 * c8) = o; }
    LDS_WAIT(); asm volatile("" ::: "memory");
}
__device__ __forceinline__ int ab_srccol(int n) { const int p = n >> 8, half = (n >> 7) & 1, i = n & 127; return (p < 4 ? 0 : 1024) + half * 512 + 128 * (p & 3) + i; }
__device__ __forceinline__ void p0_prologue(Frame& F, const Args& a) {
    LAS float* scr = (LAS float*)(F.lds + RING_OFF + F.wave * 16384);
    unsigned char* ws = a.ws;
    const int gw = F.vcu * NWAVES + F.wave, NGW = F.G * NWAVES;
    constexpr int I0 = 16 * (NAB / 32), I1 = 16 * (D / 32), I2 = 16 * (NGU / 32), I3 = (DFF / 64) * (D / 32), I4 = 16 * (NML / 32), I5 = I1, I6 = I2, I7 = I3;
    constexpr int NITEMS = I0 + I1 + I2 + I3 + I4 + I5 + I6 + I7;
    for (int it = gw; it < NITEMS; it += NGW) {
        int r = it;
        if (r < I0) { const int nblk = NAB / 32, kb = r / nblk, nb = r % nblk, n0 = 32 * nb;
            tr_item(a.in[5], NAB, ab_srccol(n0), 32, 64 * kb, (bf16*)(ws + WS_WAB), D, n0, a.in[1], 1.f, scr, F.lane); continue; } r -= I0;
        if (r < I1) { const int nblk = D / 32, kb = r / nblk, nb = r % nblk, n0 = 32 * nb;
            tr_item(a.in[18], D, n0, 32, 64 * kb, (bf16*)(ws + WS_WABO), D, n0, nullptr, 1.f, scr, F.lane); continue; } r -= I1;
        if (r < I2) { const int nblk = NGU / 32, kb = r / nblk, nb = r % nblk, n0 = 32 * nb, p = n0 >> 8, half = (n0 >> 7) & 1, i0 = n0 & 127;
            tr_item(half ? a.in[24] : a.in[23], DFF, 128 * p + i0, 32, 64 * kb, (bf16*)(ws + WS_WGU0), D, n0, a.in[3], 1.f, scr, F.lane); continue; } r -= I2;
        if (r < I3) { const int nblk = D / 32, kb = r / nblk, nb = r % nblk, n0 = 32 * nb;
            tr_item(a.in[25], D, n0, 32, 64 * kb, (bf16*)(ws + WS_WD0), DFF, n0, nullptr, 1.f, scr, F.lane); continue; } r -= I3;
        if (r < I4) { const int nblk = NML / 32, kb = r / nblk, nb = r % nblk, n0 = 32 * nb; int ncv = NML_REAL - n0; ncv = ncv < 0 ? 0 : (ncv > 32 ? 32 : ncv);
            tr_item(a.in[19], NML_REAL, n0, ncv, 64 * kb, (bf16*)(ws + WS_WML), D, n0, a.in[1] + D, (n0 >= 512 && n0 < 1024) ? 0.125f : 1.f, scr, F.lane); continue; } r -= I4;
        if (r < I5) { const int nblk = D / 32, kb = r / nblk, nb = r % nblk, n0 = 32 * nb;
            tr_item(a.in[22], D, n0, 32, 64 * kb, (bf16*)(ws + WS_WMLO), D, n0, nullptr, 1.f, scr, F.lane); continue; } r -= I5;
        if (r < I6) { const int nblk = NGU / 32, kb = r / nblk, nb = r % nblk, n0 = 32 * nb, p = n0 >> 8, half = (n0 >> 7) & 1, i0 = n0 & 127;
            tr_item((half ? a.in[24] : a.in[23]) + (size_t)D * DFF, DFF, 128 * p + i0, 32, 64 * kb, (bf16*)(ws + WS_WGU1), D, n0, a.in[3] + D, 1.f, scr, F.lane); continue; } r -= I6;
        { const int nblk = D / 32, kb = r / nblk, nb = r % nblk, n0 = 32 * nb;
            tr_item(a.in[25] + (size_t)DFF * D, D, n0, 32, 64 * kb, (bf16*)(ws + WS_WD1), DFF, n0, nullptr, 1.f, scr, F.lane); }
    }
    { const int gt = F.vcu * (NWAVES * 64) + F.tid, NGT = F.G * NWAVES * 64;
        float* bab = (float*)(ws + WS_BAB); float* bml = (float*)(ws + WS_BML);
        for (int n = gt; n < NAB; n += NGT) bab[n] = a.in[6][ab_srccol(n)];
        for (int n = gt; n < NML; n += NGT) bml[n] = (n < NML_REAL) ? a.in[20][n] * ((n >= 512 && n < 1024) ? 0.125f : 1.f) : 0.f; }
    { const float* x = a.in[0]; bf16* xb = (bf16*)(ws + WS_XB); float* rs = (float*)(ws + WS_RS);
        for (int m = gw; m < M; m += NGW) {
            const GAS f32x4* xr = (const GAS f32x4*)(x + (size_t)m * D) + F.lane;
            f32x4 v[4]; float s = 0.f;
#pragma unroll
            for (int j = 0; j < 4; ++j) { v[j] = xr[64 * j]; s += (v[j].x * v[j].x + v[j].y * v[j].y) + (v[j].z * v[j].z + v[j].w * v[j].w); }
            s = wave_sum(s);
            GAS unsigned long long* o8 = (GAS unsigned long long*)(xb + (size_t)m * D) + F.lane;
#pragma unroll
            for (int j = 0; j < 4; ++j) o8[64 * j] = (unsigned long long)cvt_pk_bf16(v[j].x, v[j].y) | ((unsigned long long)cvt_pk_bf16(v[j].z, v[j].w) << 32);
            if (F.lane == 0) rs[m] = rsqrtf(s * (1.f / D) + EPS);
        } }
}

template <bool LAST>
__device__ __forceinline__ void ew_norm(Frame& F, const float* xres, const bf16* hb, const float* gpost, float* xout, bf16* xb, float* rs) {
    const int gw = F.vcu * NWAVES + F.wave, NGW = F.G * NWAVES;
    f32x4 g[4];
#pragma unroll
    for (int j = 0; j < 4; ++j) g[j] = ((const GAS f32x4*)gpost)[F.lane + 64 * j];
    for (int m = gw; m < M; m += NGW) {
        const GAS v2u* hp = (const GAS v2u*)(hb + (size_t)m * D) + F.lane;
        const GAS f32x4* xr = (const GAS f32x4*)(xres + (size_t)m * D) + F.lane;
        f32x4 h[4], x[4]; float s = 0.f;
#pragma unroll
        for (int j = 0; j < 4; ++j) { const v2u w = hp[64 * j]; x[j] = xr[64 * j]; h[j] = (f32x4){bflo(w.x), bfhi(w.x), bflo(w.y), bfhi(w.y)};
            s += (h[j].x * h[j].x + h[j].y * h[j].y) + (h[j].z * h[j].z + h[j].w * h[j].w); }
        const float rsh = rsqrtf(wave_sum(s) * (1.f / D) + EPS); float s1 = 0.f;
#pragma unroll
        for (int j = 0; j < 4; ++j) { x[j] = x[j] + h[j] * rsh * g[j]; s1 += (x[j].x * x[j].x + x[j].y * x[j].y) + (x[j].z * x[j].z + x[j].w * x[j].w); }
        GAS f32x4* xo = (GAS f32x4*)(xout + (size_t)m * D) + F.lane;
#pragma unroll
        for (int j = 0; j < 4; ++j) xo[64 * j] = x[j];
        if (!LAST) {
            s1 = wave_sum(s1);
            GAS unsigned long long* o8 = (GAS unsigned long long*)(xb + (size_t)m * D) + F.lane;
#pragma unroll
            for (int j = 0; j < 4; ++j) o8[64 * j] = (unsigned long long)cvt_pk_bf16(x[j].x, x[j].y) | ((unsigned long long)cvt_pk_bf16(x[j].z, x[j].w) << 32);
            if (F.lane == 0) rs[m] = rsqrtf(s1 * (1.f / D) + EPS);
        }
    }
}
__device__ __forceinline__ void conf_unit(Frame& F, const Args& a, int b, int tt) {
    LAS unsigned short* ybuf = (LAS unsigned short*)(F.lds);
    LAS float* cbuf = (LAS float*)(F.lds + 63488);
    const bf16* yglu = (const bf16*)(a.ws + WS_YGLU); bf16* Y = (bf16*)(a.ws + WS_YY);
    const int t0 = tt * 32, tid = F.tid;
    for (int idx = tid; idx < 62 * 64; idx += NWAVES * 64) { const int r = idx >> 6, ch = idx & 63, t = t0 - 30 + r;
        v4u val = (v4u){0u, 0u, 0u, 0u};
        if (t >= 0) val = *(const GAS v4u*)(yglu + ((size_t)(b * SEQ + t)) * 512 + ch * 8);
        *(LAS v4u*)(ybuf + r * 512 + ch * 8) = val; }
    __syncthreads();
    {   const int c = tid; const float* cw = a.in[7]; const float cbias = a.in[8][c];
        float w[31];
#pragma unroll
        for (int k = 0; k < 31; ++k) w[k] = cw[k * 512 + c];
        float yv[62];
#pragma unroll
        for (int r = 0; r < 62; ++r) yv[r] = bf2f(ybuf[r * 512 + c]);
#pragma unroll
        for (int tl = 0; tl < 32; ++tl) { float acc = cbias;
#pragma unroll
            for (int k = 0; k < 31; ++k) acc += w[k] * yv[tl + k];
            cbuf[tl * 512 + c] = acc; }
    }
    __syncthreads();
    {   const float* lg = a.in[9]; const float* lb = a.in[10];
        f32x4 g[2], bb[2];
#pragma unroll
        for (int j = 0; j < 2; ++j) { g[j] = *(const GAS f32x4*)(lg + 4 * F.lane + 256 * j); bb[j] = *(const GAS f32x4*)(lb + 4 * F.lane + 256 * j); }
#pragma unroll
        for (int q = 0; q < 4; ++q) { const int tl = F.wave + 8 * q;
            f32x4 x[2]; float s = 0.f;
#pragma unroll
            for (int j = 0; j < 2; ++j) { x[j] = *(const LAS f32x4*)(cbuf + tl * 512 + 4 * F.lane + 256 * j); s += (x[j].x + x[j].y) + (x[j].z + x[j].w); }
            const float mean = wave_sum(s) * (1.f / 512.f); float s2 = 0.f;
#pragma unroll
            for (int j = 0; j < 2; ++j) { x[j] = x[j] - mean; s2 += (x[j].x * x[j].x + x[j].y * x[j].y) + (x[j].z * x[j].z + x[j].w * x[j].w); }
            const float rstd = rsqrtf(wave_sum(s2) * (1.f / 512.f) + EPS);
#pragma unroll
            for (int j = 0; j < 2; ++j) { f32x4 y = x[j] * rstd * g[j] + bb[j];
#pragma unroll
                for (int e = 0; e < 4; ++e) y[e] = y[e] * sigm(y[e]);
                *(GAS unsigned long long*)(Y + (size_t)(b * SEQ + t0 + tl) * D + 4 * F.lane + 256 * j) = (unsigned long long)cvt_pk_bf16(y.x, y.y) | ((unsigned long long)cvt_pk_bf16(y.z, y.w) << 32); }
        }
    }
    __syncthreads();
}
__device__ __forceinline__ void lru_unit(Frame& F, const Args& a, int b, int h, int eh) {
    LAS float* xs = (LAS float*)(F.lds);
    LAS float* segA = (LAS float*)(F.lds + 17408);
    LAS float* segB = (LAS float*)(F.lds + 19456);
    LAS float* carry = (LAS float*)(F.lds + 21504);
    const bf16* rec = (const bf16*)(a.ws + WS_REC); const bf16* ggelu = (const bf16*)(a.ws + WS_GGELU); bf16* Y = (bf16*)(a.ws + WS_YY);
    const int tid = F.tid;
    const int d = tid & 63, tg = tid >> 6;
    float w4[4];
#pragma unroll
    for (int k = 0; k < 4; ++k) w4[k] = a.in[11][k * 512 + h * 64 + d];
    const float b4 = a.in[12][h * 64 + d];
    const int e = tid & 31, sg = tid >> 5, ep = eh * 32 + e, c = h * 64 + ep;
    float Wa[64], Wx[64];
#pragma unroll
    for (int k = 0; k < 64; ++k) { Wa[k] = a.in[13][(size_t)(h * 64 + k) * 64 + ep]; Wx[k] = a.in[15][(size_t)(h * 64 + k) * 64 + ep]; }
    const float ba = a.in[14][h * 64 + ep], bx = a.in[16][h * 64 + ep];
    const float lam = a.in[17][c];
    const float lb8 = -8.0f * (fmaxf(-lam, 0.f) + log1pf(__expf(-fabsf(lam))));
    float hstate = 0.f;
    const size_t rowb = (size_t)b * SEQ;
    unsigned short rv[11];
#pragma unroll
    for (int r = 0; r < 11; ++r) { const int t = tg * 8 - 3 + r; rv[r] = (t >= 0) ? rec[(rowb + t) * 512 + h * 64 + d] : (unsigned short)0; }
    for (int tile = 0; tile < SEQ / 64; ++tile) {
        const int t0 = tile * 64;
        float rf[11];
#pragma unroll
        for (int r = 0; r < 11; ++r) rf[r] = bf2f(rv[r]);
        if (tile + 1 < SEQ / 64) {
#pragma unroll
            for (int r = 0; r < 11; ++r) rv[r] = rec[(rowb + t0 + 64 + tg * 8 - 3 + r) * 512 + h * 64 + d]; }
        unsigned short gg4[4];
#pragma unroll
        for (int i = 0; i < 4; ++i) gg4[i] = ggelu[(rowb + t0 + sg * 4 + i) * 512 + c];
#pragma unroll
        for (int i = 0; i < 8; ++i) xs[(tg * 8 + i) * 68 + d] = b4 + w4[0] * rf[i] + w4[1] * rf[i + 1] + w4[2] * rf[i + 2] + w4[3] * rf[i + 3];
        __syncthreads();
        float Ap[4], Bp[4]; float A = 1.f, B = 0.f;
#pragma unroll
        for (int i = 0; i < 4; ++i) { const int tl = sg * 4 + i; float ra = ba, rx = bx;
#pragma unroll
            for (int k4 = 0; k4 < 16; ++k4) { const f32x4 xv = *(const LAS f32x4*)(xs + tl * 68 + 4 * k4);
                ra += xv.x * Wa[4 * k4] + xv.y * Wa[4 * k4 + 1] + xv.z * Wa[4 * k4 + 2] + xv.w * Wa[4 * k4 + 3];
                rx += xv.x * Wx[4 * k4] + xv.y * Wx[4 * k4 + 1] + xv.z * Wx[4 * k4 + 2] + xv.w * Wx[4 * k4 + 3]; }
            const float r = sigm(ra), ig = sigm(rx), log_a = lb8 * r, av = __expf(log_a);
            const float gx = sqrtf(-expm1f(2.0f * log_a)) * ig * xs[tl * 68 + ep];
            B = av * B + gx; A = A * av; Ap[i] = A; Bp[i] = B; }
        segA[sg * 32 + e] = A; segB[sg * 32 + e] = B;
        __syncthreads();
        if (tid < 32) { float hh = hstate;
#pragma unroll
            for (int s = 0; s < 16; ++s) { carry[s * 32 + tid] = hh; hh = segA[s * 32 + tid] * hh + segB[s * 32 + tid]; }
            hstate = hh; }
        __syncthreads();
        const float cin = carry[sg * 32 + e];
#pragma unroll
        for (int i = 0; i < 4; ++i) { const float hv = Ap[i] * cin + Bp[i];
            const float o = hv * bf2f(gg4[i]);
            Y[(rowb + t0 + sg * 4 + i) * D + 512 + c] = (bf16)(cvt_pk_bf16(o, 0.f) & 0xffffu); }
    }
    __syncthreads();
}
typedef float f32x16 __attribute__((ext_vector_type(16)));
#define MFMA32(a, b, c) __builtin_amdgcn_mfma_f32_32x32x16_bf16((a), (b), (c), 0, 0, 0)
__device__ __forceinline__ int crow(int reg, int hh) { return (reg & 3) + 8 * (reg >> 2) + 4 * hh; }
constexpr int ML_QS = 0, ML_QI = 9216, ML_KS = 18432, ML_KW = 27648, ML_PS = 36864, ML_CT = 46080, ML_VS = 64512, ML_F = 80896;
__device__ __forceinline__ bf16x8 gather8(const LAS unsigned short* p, int pitch  ) {
    bf16x8 r;
#pragma unroll
    for (int i = 0; i < 8; ++i) r[i] = (short)p[i * pitch];
    return r;
}
__device__ __forceinline__ void mlstm_unit(Frame& F, const Args& a, int b, int h) {
    LAS unsigned char* L = F.lds;
    LAS float* bcum = (LAS float*)(L + ML_F); LAS float* gg = bcum + 64; LAS float* pm = bcum + 128; LAS float* nvec = bcum + 192; LAS float* qn = bcum + 256; LAS float* dens = bcum + 320; LAS float* hp = bcum + 384;
    const bf16* Qg = (const bf16*)(a.ws + WS_Q); const bf16* Kg = (const bf16*)(a.ws + WS_K); const bf16* Vg = (const bf16*)(a.ws + WS_V); const bf16* So = (const bf16*)(a.ws + WS_SO);
    const float* Gt = (const float*)(a.ws + WS_GT); bf16* Yh = (bf16*)(a.ws + WS_YY); const float* hg = a.in[21];
    const int tid = F.tid, lane = F.lane, wave = F.wave, r = lane & 31, hh = lane >> 5;
    const int row = tid >> 3, ch = tid & 7;
    const int jb = wave >> 2, vb = wave & 3;
    f32x16 accC;
#pragma unroll
    for (int i = 0; i < 16; ++i) accC[i] = 0.f;
    for (int i = tid; i < 18432 / 16; i += NWAVES * 64) *(LAS v4u*)(L + ML_CT + i * 16) = (v4u){0u, 0u, 0u, 0u};
    if (tid < 64) nvec[tid] = 0.f;
    float m_state = 0.f;
    const size_t rowb = (size_t)b * SEQ;
    v4u qc, kc, vc[2], qx, kx, vx[2]; float igc = 0.f, lfc = 0.f, igx = 0.f, lfx = 0.f;
    {   const size_t t = rowb + row;
        qc = *(const GAS v4u*)(Qg + t * 512 + h * 64 + ch * 8); kc = *(const GAS v4u*)(Kg + t * 512 + h * 64 + ch * 8);
#pragma unroll
        for (int i = 0; i < 2; ++i) { const int idx2 = tid + 512 * i; vc[i] = *(const GAS v4u*)(Vg + (rowb + (idx2 >> 4)) * 1024 + h * 128 + (idx2 & 15) * 8); }
        if (tid < 64) { igc = Gt[(rowb + tid) * 16 + h]; lfc = Gt[(rowb + tid) * 16 + 8 + h]; } }
    const float hgv = hg[h * 128 + vb * 32 + r];
    for (int c = 0; c < SEQ / 64; ++c) {
        const size_t tok0 = rowb + (size_t)c * 64;
        *(LAS v4u*)(L + ML_QS + row * 144 + ch * 16) = qc; *(LAS v4u*)(L + ML_KS + row * 144 + ch * 16) = kc;
#pragma unroll
        for (int i = 0; i < 2; ++i) { const int idx2 = tid + 512 * i; *(LAS v4u*)(L + ML_VS + (idx2 >> 4) * 256 + (idx2 & 15) * 16) = vc[i]; }
        if (tid < 64) { float bc = lfc;
#pragma unroll
            for (int o = 1; o < 64; o <<= 1) { const float t = __shfl_up(bc, o); if (lane >= o) bc += t; }
            const float g = igc - bc; float px = g;
#pragma unroll
            for (int o = 1; o < 64; o <<= 1) { const float t = __shfl_up(px, o); if (lane >= o) px = fmaxf(px, t); }
            px = fmaxf(px, m_state);
            bcum[lane] = bc; gg[lane] = g; pm[lane] = px; }
        unsigned short so[16];
#pragma unroll
        for (int i = 0; i < 16; ++i) so[i] = So[(tok0 + jb * 32 + crow(i, hh)) * 1024 + h * 128 + vb * 32 + r];
        if (c + 1 < SEQ / 64) { const size_t t = tok0 + 64 + row;
            qx = *(const GAS v4u*)(Qg + t * 512 + h * 64 + ch * 8); kx = *(const GAS v4u*)(Kg + t * 512 + h * 64 + ch * 8);
#pragma unroll
            for (int i = 0; i < 2; ++i) { const int idx2 = tid + 512 * i; vx[i] = *(const GAS v4u*)(Vg + (tok0 + 64 + (idx2 >> 4)) * 1024 + h * 128 + (idx2 & 15) * 8); }
            if (tid < 64) { igx = Gt[(tok0 + 64 + tid) * 16 + h]; lfx = Gt[(tok0 + 64 + tid) * 16 + 8 + h]; } }
        __syncthreads();
        if (wave < 4) { const int sjb = wave >> 1, sb = wave & 1;
            f32x16 acc;
#pragma unroll
            for (int i = 0; i < 16; ++i) acc[i] = 0.f;
#pragma unroll
            for (int kk = 0; kk < 4; ++kk) { const bf16x8 av = *(const LAS bf16x8*)(L + ML_QS + (sjb * 32 + r) * 144 + (kk * 16 + 8 * hh) * 2);
                const bf16x8 bv = *(const LAS bf16x8*)(L + ML_KS + (sb * 32 + r) * 144 + (kk * 16 + 8 * hh) * 2); acc = MFMA32(av, bv, acc); }
            const int s = sb * 32 + r; const float gs = gg[s];
#pragma unroll
            for (int i = 0; i < 16; ++i) { const int j = sjb * 32 + crow(i, hh); const float p = (s <= j) ? acc[i] * __expf(gs - pm[j]) : 0.f;
                *(LAS unsigned short*)(L + ML_PS + j * 144 + s * 2) = (unsigned short)(cvt_pk_bf16(p, 0.f) & 0xffffu); } }
        {   const float pmr = pm[row], iw = __expf(m_state - pmr), ws = __expf(gg[row] - pm[63]);
            const unsigned qw[4] = {qc.x, qc.y, qc.z, qc.w}, kw[4] = {kc.x, kc.y, kc.z, kc.w};
            unsigned qop[4], kop[4]; float dot = 0.f;
            const f32x4 n0 = *(const LAS f32x4*)(nvec + ch * 8), n1 = *(const LAS f32x4*)(nvec + ch * 8 + 4);
            const float nn[8] = {n0.x, n0.y, n0.z, n0.w, n1.x, n1.y, n1.z, n1.w};
#pragma unroll
            for (int e2 = 0; e2 < 4; ++e2) { const float q0 = bflo(qw[e2]), q1 = bfhi(qw[e2]), k0 = bflo(kw[e2]), k1 = bfhi(kw[e2]);
                dot += q0 * nn[2 * e2] + q1 * nn[2 * e2 + 1];
                qop[e2] = cvt_pk_bf16(q0 * iw, q1 * iw); kop[e2] = cvt_pk_bf16(k0 * ws, k1 * ws); }
            dot += __shfl_xor(dot, 1); dot += __shfl_xor(dot, 2); dot += __shfl_xor(dot, 4);
            *(LAS v4u*)(L + ML_QI + row * 144 + ch * 16) = (v4u){qop[0], qop[1], qop[2], qop[3]}; *(LAS v4u*)(L + ML_KW + row * 144 + ch * 16) = (v4u){kop[0], kop[1], kop[2], kop[3]};
            if (ch == 0) qn[row] = iw * dot; }
        __syncthreads();
        bf16x8 vf[4];
#pragma unroll
        for (int kk = 0; kk < 4; ++kk) vf[kk] = gather8((const LAS unsigned short*)(L + ML_VS + (kk * 16 + 8 * hh) * 256 + (vb * 32 + r) * 2), 128);
        f32x16 acc2;
#pragma unroll
        for (int i = 0; i < 16; ++i) acc2[i] = 0.f;
#pragma unroll
        for (int kk = 0; kk < 4; ++kk) { const bf16x8 av = *(const LAS bf16x8*)(L + ML_PS + (jb * 32 + r) * 144 + (kk * 16 + 8 * hh) * 2); acc2 = MFMA32(av, vf[kk], acc2); }
#pragma unroll
        for (int kk = 0; kk < 4; ++kk) { const bf16x8 av = *(const LAS bf16x8*)(L + ML_QI + (jb * 32 + r) * 144 + (kk * 16 + 8 * hh) * 2);
            const bf16x8 bv = *(const LAS bf16x8*)(L + ML_CT + (vb * 32 + r) * 144 + (kk * 16 + 8 * hh) * 2); acc2 = MFMA32(av, bv, acc2); }
        {   const v4u pw = *(const LAS v4u*)(L + ML_PS + row * 144 + ch * 16);
            float ps = (bflo(pw.x) + bfhi(pw.x)) + (bflo(pw.y) + bfhi(pw.y)) + (bflo(pw.z) + bfhi(pw.z)) + (bflo(pw.w) + bfhi(pw.w));
            ps += __shfl_xor(ps, 1); ps += __shfl_xor(ps, 2); ps += __shfl_xor(ps, 4);
            if (ch == 0) dens[row] = ps + qn[row]; }
        __syncthreads();
        float hv[16];
#pragma unroll
        for (int i = 0; i < 16; ++i) { const int j = jb * 32 + crow(i, hh); const float dn = fmaxf(fabsf(dens[j]), __expf(-(bcum[j] + pm[j]))); hv[i] = acc2[i] / dn;
            float q = hv[i] * hv[i]; q += __shfl_xor(q, 1); q += __shfl_xor(q, 2); q += __shfl_xor(q, 4); q += __shfl_xor(q, 8); q += __shfl_xor(q, 16);
            if (r == 0) hp[j * 4 + vb] = q; }
        const float pm63 = pm[63], dec = __expf(m_state - pm63), m_new = bcum[63] + pm63;
#pragma unroll
        for (int i = 0; i < 16; ++i) accC[i] *= dec;
#pragma unroll
        for (int kk = 0; kk < 4; ++kk) { const bf16x8 av = gather8((const LAS unsigned short*)(L + ML_KW + (kk * 16 + 8 * hh) * 144 + (jb * 32 + r) * 2), 72); accC = MFMA32(av, vf[kk], accC); }
        {   const LAS unsigned short* kp = (const LAS unsigned short*)(L + ML_KW + (ch * 8) * 144 + row * 2);
            float s = 0.f;
#pragma unroll
            for (int e2 = 0; e2 < 8; ++e2) s += bf2f(kp[e2 * 72]);
            s += __shfl_xor(s, 1); s += __shfl_xor(s, 2); s += __shfl_xor(s, 4);
            if (ch == 0) nvec[row] = dec * nvec[row] + s; }
        __syncthreads();
#pragma unroll
        for (int g4 = 0; g4 < 4; ++g4) { v2u w; w.x = cvt_pk_bf16(accC[4 * g4], accC[4 * g4 + 1]); w.y = cvt_pk_bf16(accC[4 * g4 + 2], accC[4 * g4 + 3]);
            *(LAS v2u*)(L + ML_CT + (vb * 32 + r) * 144 + (jb * 32 + 8 * g4 + 4 * hh) * 2) = w; }
#pragma unroll
        for (int i = 0; i < 16; ++i) { const int j = jb * 32 + crow(i, hh); const f32x4 q4 = *(const LAS f32x4*)(hp + j * 4);
            const float rsn = rsqrtf(((q4.x + q4.y) + (q4.z + q4.w)) * (1.f / 128.f) + EPS);
            const float o = hv[i] * rsn * hgv * bf2f(so[i]);
            Yh[(tok0 + j) * 1024 + h * 128 + vb * 32 + r] = (bf16)(cvt_pk_bf16(o, 0.f) & 0xffffu); }
        m_state = m_new; qc = qx; kc = kx; vc[0] = vx[0]; vc[1] = vx[1]; igc = igx; lfc = lfx;
    }
    __syncthreads();
}
__global__ void __launch_bounds__(NWAVES * 64, 2) mk_fwd(Args args) {
    extern __shared__ __attribute__((aligned(16))) unsigned char lds[];
    Frame F;
    F.lds = (LAS unsigned char*)lds;
    F.MISC = (volatile LAS unsigned*)(F.lds + MISC_OFF);
    F.tid = threadIdx.x; F.lane = F.tid & 63; F.wave = __builtin_amdgcn_readfirstlane(F.tid >> 6);
    F.G = gridDim.x; { const int bx = blockIdx.x; F.vcu = (F.G % 8 == 0) ? (bx % 8) * (F.G / 8) + bx / 8 : bx; }
    unsigned char* ws = args.ws;
    F.ctl = (gu32*)(ws + WS_CTL);
    for (int u = F.tid; u < (LDS_BYTES - LDSCTL_OFF) / 4; u += NWAVES * 64) ((LAS unsigned*)(F.lds + LDSCTL_OFF))[u] = 0u;
    __syncthreads();
    XcdBarrier bar; bar.bar = (unsigned*)(F.ctl + CW_BAR); bar.x = 0; bar.st = nullptr;
    if (N_LAUNCHES == 1) bar = xcd_barrier_post((unsigned*)(F.ctl + CW_BAR), F.MISC + 8);
#define GRID_BAR(seam) do { if (N_LAUNCHES == 1) xcd_barrier(bar); } while (0)
    const int lo = args.ph_lo, hi = args.ph_hi;
#define IN(k) (lo <= (k) && (k) < hi)
#define BOTH(k) (IN(k) && IN((k) + 1))
    bf16* XB = (bf16*)(ws + WS_XB); bf16* HB = (bf16*)(ws + WS_HB); bf16* YY = (bf16*)(ws + WS_YY); float* RS = (float*)(ws + WS_RS);
    const int bx = (int)blockIdx.x;

    if (IN(0)) { p0_prologue(F, args); if (BOTH(0)) GRID_BAR(0); }
    if (IN(1)) { pg8::Gemm g{XB, (const bf16*)(ws + WS_WAB), M, NAB, D}; pg8::StaticOrder S; S.init(M, NAB, F.G, bx);
        pg8::EpiAB E{(bf16*)(ws + WS_YGLU), (bf16*)(ws + WS_GGELU), (bf16*)(ws + WS_REC), RS, (const float*)(ws + WS_BAB)};
        pg8::gemm_phase<pg8::EpiAB, pg8::StaticOrder, true, true>(F.lds + RING_OFF, g, S, E);
        if (BOTH(1)) GRID_BAR(1); }
    if (IN(2)) {
        if (bx < 256) lru_unit(F, args, bx >> 4, (bx >> 1) & 7, bx & 1);
        for (int i = bx; i < BATCH * (SEQ / 32); i += F.G) conf_unit(F, args, i >> 6, i & 63);
        if (BOTH(2)) GRID_BAR(2); }
    if (IN(3)) { pg8::Gemm g{YY, (const bf16*)(ws + WS_WABO), M, D, D}; pg8::StaticOrder S; S.init(M, D, F.G, bx);
        pg8::EpiPlain E{HB, D};
        pg8::gemm_phase<pg8::EpiPlain, pg8::StaticOrder, true, true>(F.lds + RING_OFF, g, S, E);
        if (BOTH(3)) GRID_BAR(3); }
    if (IN(4)) { ew_norm<false>(F, args.in[0], HB, args.in[2], args.out, XB, RS); if (BOTH(4)) GRID_BAR(4); }
    if (IN(5)) { pg8::Gemm g{XB, (const bf16*)(ws + WS_WGU0), M, NGU, D}; pg8::StaticOrder S; S.init(M, NGU, F.G, bx);
        pg8::EpiSwiGLU E{(bf16*)(ws + WS_HMID), RS, DFF};
        pg8::gemm_phase<pg8::EpiSwiGLU, pg8::StaticOrder, true, true>(F.lds + RING_OFF, g, S, E);
        if (BOTH(5)) GRID_BAR(5); }
    if (IN(6)) { pg8::Gemm g{(const bf16*)(ws + WS_HMID), (const bf16*)(ws + WS_WD0), M, D, DFF}; pg8::StaticOrder S; S.init(M, D, F.G, bx);
        pg8::EpiPlain E{HB, D};
        pg8::gemm_phase<pg8::EpiPlain, pg8::StaticOrder, true, true>(F.lds + RING_OFF, g, S, E);
        if (BOTH(6)) GRID_BAR(6); }
    if (IN(7)) { ew_norm<false>(F, args.out, HB, args.in[4], args.out, XB, RS); if (BOTH(7)) GRID_BAR(7); }
    if (IN(8)) { pg8::Gemm g{XB, (const bf16*)(ws + WS_WML), M, NML, D}; pg8::StaticOrder S; S.init(M, NML, F.G, bx);
        pg8::EpiML E{(bf16*)(ws + WS_Q), (bf16*)(ws + WS_K), (bf16*)(ws + WS_V), (bf16*)(ws + WS_SO), (float*)(ws + WS_GT), RS, (const float*)(ws + WS_BML)};
        pg8::gemm_phase<pg8::EpiML, pg8::StaticOrder, true, true>(F.lds + RING_OFF, g, S, E);
        if (BOTH(8)) GRID_BAR(8); }
    if (IN(9)) { if (bx < BATCH * 8) mlstm_unit(F, args, bx >> 3, bx & 7); if (BOTH(9)) GRID_BAR(9); }
    if (IN(10)) { pg8::Gemm g{YY, (const bf16*)(ws + WS_WMLO), M, D, D}; pg8::StaticOrder S; S.init(M, D, F.G, bx);
        pg8::EpiPlain E{HB, D};
        pg8::gemm_phase<pg8::EpiPlain, pg8::StaticOrder, true, true>(F.lds + RING_OFF, g, S, E);
        if (BOTH(10)) GRID_BAR(10); }
    if (IN(11)) { ew_norm<false>(F, args.out, HB, args.in[2] + D, args.out, XB, RS); if (BOTH(11)) GRID_BAR(11); }
    if (IN(12)) { pg8::Gemm g{XB, (const bf16*)(ws + WS_WGU1), M, NGU, D}; pg8::StaticOrder S; S.init(M, NGU, F.G, bx);
        pg8::EpiSwiGLU E{(bf16*)(ws + WS_HMID), RS, DFF};
        pg8::gemm_phase<pg8::EpiSwiGLU, pg8::StaticOrder, true, true>(F.lds + RING_OFF, g, S, E);
        if (BOTH(12)) GRID_BAR(12); }
    if (IN(13)) { pg8::Gemm g{(const bf16*)(ws + WS_HMID), (const bf16*)(ws + WS_WD1), M, D, DFF}; pg8::StaticOrder S; S.init(M, D, F.G, bx);
        pg8::EpiPlain E{HB, D};
        pg8::gemm_phase<pg8::EpiPlain, pg8::StaticOrder, true, true>(F.lds + RING_OFF, g, S, E);
        if (BOTH(13)) GRID_BAR(13); }
    if (IN(14)) { ew_norm<true>(F, args.out, HB, args.in[4] + D, args.out, XB, RS); }
#undef IN
#undef BOTH
#undef GRID_BAR
}

extern "C" void kernel_launch(void* const* d_in, const int* in_sizes, int n_in, void* d_out, int out_size, void* d_ws, size_t ws_size, hipStream_t stream) {
    static int grid = 0;
    if (grid == 0) {
        if (n_in != 26 || in_sizes[0] != M * D || out_size != M * D || ws_size < WS_END) { fprintf(stderr, "kernel_launch: unexpected shapes (n_in %d, in0 %d, out %d, ws %zu); nothing launched\n", n_in, n_in > 0 ? in_sizes[0] : -1, out_size, ws_size); grid = -1; return; }
        int dev = 0, cus = 0, per_cu = 0;
        if (hipGetDevice(&dev) != hipSuccess || hipDeviceGetAttribute(&cus, hipDeviceAttributeMultiprocessorCount, dev) != hipSuccess) { fprintf(stderr, "kernel_launch: device query failed\n"); grid = -1; return; }
        if (hipFuncSetAttribute((const void*)mk_fwd, hipFuncAttributeMaxDynamicSharedMemorySize, LDS_BYTES) != hipSuccess) { fprintf(stderr, "kernel_launch: hipFuncSetAttribute failed\n"); grid = -1; return; }
        if (hipOccupancyMaxActiveBlocksPerMultiprocessor(&per_cu, (const void*)mk_fwd, NWAVES * 64, LDS_BYTES) != hipSuccess || per_cu < 1)
            fprintf(stderr, "kernel_launch: note: occupancy query reports %d workgroups per CU\n", per_cu);
        (void)hipGetLastError();
        grid = cus;
    }
    if (grid < 0) return;
    if (hipMemsetAsync((char*)d_ws + WS_CTL, 0, CTL_ZERO_BYTES, stream) != hipSuccess) { fprintf(stderr, "kernel_launch: hipMemsetAsync failed\n"); return; }
    Args a{};
    for (int i = 0; i < 26; ++i) a.in[i] = (const float*)d_in[i];
    a.out = (float*)d_out; a.ws = (unsigned char*)d_ws;
    for (int li = 0; li < N_LAUNCHES; ++li) {
        a.ph_lo = (N_LAUNCHES == NPH) ? li : 0; a.ph_hi = (N_LAUNCHES == NPH) ? li + 1 : NPH; a.li = li;
        hipLaunchKernelGGL(mk_fwd, dim3(grid), dim3(NWAVES * 64), LDS_BYTES, stream, a);
        const hipError_t le = hipPeekAtLastError();
        if (le != hipSuccess) { fprintf(stderr, "kernel_launch: launch %d failed: %s\n", li, hipGetErrorName(le)); break; }
    }
}
```
